# Optimizing an MI355X kernel written in HIP

```python
import jax
import jax.numpy as jnp
from jax import lax
import numpy as np

D_MODEL = 1024
BATCH = 2
SEQ = 8192
DEPTH = 4

GRID_W = 64
CTX_LEN = 256
N_MIXERS = 3
N_CONV_LAYERS = (DEPTH + N_MIXERS - 1) // N_MIXERS
N_ATTN_LAYERS = (DEPTH + N_MIXERS - 2) // N_MIXERS
N_LRU_LAYERS = DEPTH // N_MIXERS
N_MOD = 6
EPS = 1e-6

CONV_WIDTH = 31

HEAD_DIM = 64
N_HEADS = D_MODEL // HEAD_DIM
N_KV_HEADS = 4
GQA_GROUP = N_HEADS // N_KV_HEADS
Q_DIM = N_HEADS * HEAD_DIM
KV_DIM = N_KV_HEADS * HEAD_DIM
WINDOW = 128
ATTN_BLOCK = 128
ROPE_BASE = 10000.0
ROPE_PAIRS = HEAD_DIM // 4

D_RNN = D_MODEL
LRU_BLOCKS = 8
LRU_BLOCK_DIM = D_RNN // LRU_BLOCKS
LRU_CONV_W = 4
LRU_C = 8.0

N_EXPERTS = 16
N_GROUPS = 4
EXPERTS_PER_GROUP = N_EXPERTS // N_GROUPS
TOP_K = 2
D_EXPERT = 512
MOE_BLOCK = 128

kernel_name = 'hybrid_conv_swa_rglru_moe_dit'


def rmsnorm(x, g):
    x32 = x.astype(jnp.float32)
    y = x32 * lax.rsqrt(jnp.mean(x32 * x32, axis=-1, keepdims=True) + EPS)
    return (y * g.astype(jnp.float32)).astype(x.dtype)


def layernorm(x, g, b):
    x32 = x.astype(jnp.float32)
    mu = jnp.mean(x32, axis=-1, keepdims=True)
    xc = x32 - mu
    var = jnp.mean(xc * xc, axis=-1, keepdims=True)
    return (xc * lax.rsqrt(var + EPS) * g.astype(jnp.float32) + b.astype(jnp.float32)).astype(x.dtype)


def modulate(h, shift, scale):
    return h * (1.0 + scale) + shift


def depthwise_conv(u, w, b, pad):
    y = lax.conv_general_dilated(u, w[:, None, :].astype(u.dtype), window_strides=(1,), padding=[pad],
                                 dimension_numbers=('NWC', 'WIO', 'NWC'), feature_group_count=u.shape[-1])
    return y + b.astype(u.dtype)


def conformer_conv(h, pw1, pw1_b, dw, dw_b, ln_g, ln_b, pw2, pw2_b):
    u = h @ pw1 + pw1_b
    u = u[..., :D_MODEL] * jax.nn.sigmoid(u[..., D_MODEL:])
    half = (CONV_WIDTH - 1) // 2
    u = depthwise_conv(u, dw, dw_b, (half, half))
    u = jax.nn.silu(layernorm(u, ln_g, ln_b))
    return u @ pw2 + pw2_b


def axial_rope_tables(rows, cols):
    inv = ROPE_BASE ** (-jnp.arange(ROPE_PAIRS, dtype=jnp.float32) / ROPE_PAIRS)
    ar = rows.astype(jnp.float32)[:, None] * inv
    ac = cols.astype(jnp.float32)[:, None] * inv
    ang = jnp.concatenate([ar, ar, ac, ac], axis=-1)
    return jnp.cos(ang), jnp.sin(ang)


def apply_rope(x, cos, sin):
    xr = x.reshape(x.shape[:-1] + (2, 2, ROPE_PAIRS))
    rot = jnp.stack([-xr[..., 1, :], xr[..., 0, :]], axis=-2).reshape(x.shape)
    return x * cos.astype(x.dtype) + rot * sin.astype(x.dtype)


def sink_softmax_av(parts, sink):
    sink_b = sink.astype(jnp.float32).reshape(1, N_KV_HEADS, GQA_GROUP, 1)
    m = sink_b
    for s, _ in parts:
        m = jnp.maximum(m, jnp.max(s, axis=-1))
    den = jnp.exp(sink_b - m)
    out = 0.0
    for s, v in parts:
        p = jnp.exp(s - m[..., None])
        den = den + jnp.sum(p, axis=-1)
        out = out + jnp.einsum('bkgqs,bskd->bqkgd', p, v.astype(jnp.float32))
    return out / jnp.transpose(den, (0, 3, 1, 2))[..., None]


def windowed_sink_gqa(hc, hl, w_qkv, w_o, sink, cos, sin):
    B, S, _ = hl.shape
    L = hc.shape[1]
    nb = S // ATTN_BLOCK
    scale = HEAD_DIM ** -0.5

    def qkv(h):
        t = h @ w_qkv
        n = h.shape[1]
        q = t[..., :Q_DIM].reshape(B, n, N_KV_HEADS, GQA_GROUP, HEAD_DIM) * scale
        k = t[..., Q_DIM:Q_DIM + KV_DIM].reshape(B, n, N_KV_HEADS, HEAD_DIM)
        v = t[..., Q_DIM + KV_DIM:].reshape(B, n, N_KV_HEADS, HEAD_DIM)
        return q, k, v

    qc, kc, vc = qkv(hc)
    ql, kl, vl = qkv(hl)
    ql = apply_rope(ql, cos[None, :, None, None, :], sin[None, :, None, None, :])
    kl = apply_rope(kl, cos[None, :, None, :], sin[None, :, None, :])

    s_cc = jnp.einsum('bqkgd,bckd->bkgqc', qc, kc, preferred_element_type=jnp.float32)
    oc = sink_softmax_av([(s_cc, vc)], sink).reshape(B, L, Q_DIM)

    span = ATTN_BLOCK + 2 * WINDOW
    kp = jnp.pad(kl, ((0, 0), (WINDOW, WINDOW), (0, 0), (0, 0)))
    vp = jnp.pad(vl, ((0, 0), (WINDOW, WINDOW), (0, 0), (0, 0)))
    qb = jnp.swapaxes(ql.reshape(B, nb, ATTN_BLOCK, N_KV_HEADS, GQA_GROUP, HEAD_DIM), 0, 1)
    rel = jnp.arange(ATTN_BLOCK)[:, None] - (jnp.arange(span)[None, :] - WINDOW)
    band = jnp.abs(rel) <= WINDOW

    def block(args):
        j, q = args
        start = j * ATTN_BLOCK
        k = lax.dynamic_slice_in_dim(kp, start, span, axis=1)
        v = lax.dynamic_slice_in_dim(vp, start, span, axis=1)
        kpos = start - WINDOW + jnp.arange(span)
        valid = band & ((kpos >= 0) & (kpos < S))[None, :]
        s_ll = jnp.einsum('bqkgd,bskd->bkgqs', q, k, preferred_element_type=jnp.float32)
        s_ll = jnp.where(valid, s_ll, -jnp.inf)
        s_lc = jnp.einsum('bqkgd,bckd->bkgqc', q, kc, preferred_element_type=jnp.float32)
        return sink_softmax_av([(s_ll, v), (s_lc, vc)], sink)

    ol = lax.map(block, (jnp.arange(nb), qb))
    ol = jnp.swapaxes(ol, 0, 1).reshape(B, S, Q_DIM)
    return oc.astype(hc.dtype) @ w_o, ol.astype(hl.dtype) @ w_o


def _linear_combine(e1, e2):
    a1, b1 = e1
    a2, b2 = e2
    return a1 * a2, a2 * b1 + b2


def rglru_scan(u, wa, ba, wx, bx, lam, h0):
    B, N, _ = u.shape
    ub = u.reshape(B, N, LRU_BLOCKS, LRU_BLOCK_DIM)
    r = jax.nn.sigmoid(jnp.einsum('bnhi,hij->bnhj', ub, wa, preferred_element_type=jnp.float32).reshape(B, N, D_RNN) + ba)
    gi = jax.nn.sigmoid(jnp.einsum('bnhi,hij->bnhj', ub, wx, preferred_element_type=jnp.float32).reshape(B, N, D_RNN) + bx)
    log_a = -LRU_C * jax.nn.softplus(-lam.astype(jnp.float32)) * r
    a = jnp.exp(log_a)
    b = jnp.sqrt(-jnp.expm1(2.0 * log_a)) * (gi * u.astype(jnp.float32))
    b = b.at[:, 0].add(a[:, 0] * h0)
    _, h = lax.associative_scan(_linear_combine, (a, b), axis=1)
    return h, h[:, -1]


def _orient(t, backward):
    return t[:, ::-1] if backward else t


def bidir_rglru(hc, hl, w_in, conv_w, conv_b, wa, ba, wx, bx, lam, w_out):
    def branches(h):
        t = h @ w_in
        return t[..., :D_RNN], jax.nn.gelu(t[..., D_RNN:])

    uc, gc = branches(hc)
    ul, gl = branches(hl)
    B = hl.shape[0]
    yc = jnp.zeros(uc.shape, jnp.float32)
    yl = jnp.zeros(ul.shape, jnp.float32)
    for d in range(2):
        back = d == 1
        pad = (LRU_CONV_W - 1, 0)
        cc = depthwise_conv(_orient(uc, back), conv_w[d], conv_b[d], pad)
        cl = depthwise_conv(_orient(ul, back), conv_w[d], conv_b[d], pad)
        hc_seq, h_ctx = rglru_scan(cc, wa[d], ba[d], wx[d], bx[d], lam[d], jnp.zeros((B, D_RNN), jnp.float32))
        hl_seq, _ = rglru_scan(cl, wa[d], ba[d], wx[d], bx[d], lam[d], h_ctx)
        yc = yc + _orient(hc_seq, back)
        yl = yl + _orient(hl_seq, back)
    oc = (yc * gc.astype(jnp.float32)).astype(hc.dtype) @ w_out
    ol = (yl * gl.astype(jnp.float32)).astype(hl.dtype) @ w_out
    return oc, ol


def route(ht, w_router, router_bias):
    T = ht.shape[0]
    s = jax.nn.sigmoid(jnp.matmul(ht, w_router, preferred_element_type=jnp.float32))
    sel = (s + router_bias.astype(jnp.float32)).reshape(T, N_GROUPS, EXPERTS_PER_GROUP)
    group_score = jnp.sum(lax.top_k(sel, 2)[0], axis=-1)
    grp = jnp.argmax(group_score, axis=-1)
    _, loc = lax.top_k(sel[jnp.arange(T), grp], TOP_K)
    idx = grp[:, None] * EXPERTS_PER_GROUP + loc
    w = jnp.take_along_axis(s, idx, axis=1)
    return idx.astype(jnp.int32), w / jnp.sum(w, axis=-1, keepdims=True)


def moe(h, w_router, router_bias, w1, w3, w2):
    shp = h.shape
    ht = h.reshape(-1, shp[-1])
    T = ht.shape[0]
    idx, gate = route(ht, w_router, router_bias)
    A = T * TOP_K
    flat_e = idx.reshape(-1)
    flat_t = jnp.repeat(jnp.arange(T, dtype=jnp.int32), TOP_K)
    flat_g = gate.reshape(-1)
    order = jnp.argsort(flat_e)
    se = flat_e[order]
    counts = jnp.bincount(flat_e, length=N_EXPERTS)
    padded = (counts + MOE_BLOCK - 1) // MOE_BLOCK * MOE_BLOCK
    pend = jnp.cumsum(padded)
    pstart = pend - padded
    cstart = jnp.cumsum(counts) - counts
    dest = pstart[se] + jnp.arange(A, dtype=jnp.int32) - cstart[se]
    n_slots = -(-A // MOE_BLOCK) * MOE_BLOCK + N_EXPERTS * MOE_BLOCK
    n_blocks = n_slots // MOE_BLOCK
    slot_tok = jnp.zeros((n_slots,), jnp.int32).at[dest].set(flat_t[order])
    slot_gate = jnp.zeros((n_slots,), jnp.float32).at[dest].set(flat_g[order])
    blk_e = jnp.minimum(jnp.searchsorted(pend, jnp.arange(n_blocks, dtype=jnp.int32) * MOE_BLOCK, side='right'),
                        N_EXPERTS - 1)

    def expert_block(args):
        e, tok, g = args
        xb = ht[tok]
        hid = jax.nn.silu(xb @ w1[e]) * (xb @ w3[e])
        return (hid @ w2[e]) * g[:, None].astype(ht.dtype)

    yb = lax.map(expert_block, (blk_e, slot_tok.reshape(n_blocks, MOE_BLOCK), slot_gate.reshape(n_blocks, MOE_BLOCK)))
    out = jnp.zeros_like(ht).at[slot_tok].add(yb.reshape(n_slots, -1))
    return out.reshape(shp)


def setup_inputs(seed: int = 0) -> dict:
    key = jax.random.key(seed)
    keys = iter(jax.random.split(key, 48))

    def nrm(shape, scale):
        return jax.random.normal(next(keys), shape, jnp.float32) * scale

    D = D_MODEL
    nC, nA, nL = N_CONV_LAYERS, N_ATTN_LAYERS, N_LRU_LAYERS
    u = jax.random.uniform(next(keys), (nL, 2, D_RNN), jnp.float32, 0.9, 0.999)
    p = u ** (1.0 / LRU_C)
    return {
        'x': nrm((BATCH, SEQ, D), 1.0),
        'c': nrm((BATCH, D), 1.0),
        'ctx': nrm((BATCH, CTX_LEN, D), 1.0),
        'c_ctx': nrm((D,), 1.0),
        'w_mod': nrm((DEPTH, D, N_MOD * D), 0.5 * D ** -0.5),
        'b_mod': nrm((DEPTH, N_MOD * D), 0.02),
        'norm_mix': 1.0 + nrm((DEPTH, D), 0.02),
        'norm_ffn': 1.0 + nrm((DEPTH, D), 0.02),
        'norm_f': 1.0 + nrm((D,), 0.02),
        'conv_pw1': nrm((nC, D, 2 * D), D ** -0.5),
        'conv_pw1_b': nrm((nC, 2 * D), 0.02),
        'conv_dw': nrm((nC, CONV_WIDTH, D), CONV_WIDTH ** -0.5),
        'conv_dw_b': nrm((nC, D), 0.02),
        'conv_ln_g': 1.0 + nrm((nC, D), 0.02),
        'conv_ln_b': nrm((nC, D), 0.02),
        'conv_pw2': nrm((nC, D, D), D ** -0.5),
        'conv_pw2_b': nrm((nC, D), 0.02),
        'attn_w_qkv': nrm((nA, D, Q_DIM + 2 * KV_DIM), D ** -0.5),
        'attn_w_o': nrm((nA, Q_DIM, D), Q_DIM ** -0.5),
        'attn_sink': nrm((nA, N_HEADS), 0.5),
        'lru_w_in': nrm((nL, D, 2 * D_RNN), D ** -0.5),
        'lru_conv_w': nrm((nL, 2, LRU_CONV_W, D_RNN), LRU_CONV_W ** -0.5),
        'lru_conv_b': nrm((nL, 2, D_RNN), 0.02),
        'lru_wa': nrm((nL, 2, LRU_BLOCKS, LRU_BLOCK_DIM, LRU_BLOCK_DIM), LRU_BLOCK_DIM ** -0.5),
        'lru_ba': nrm((nL, 2, D_RNN), 0.02),
        'lru_wx': nrm((nL, 2, LRU_BLOCKS, LRU_BLOCK_DIM, LRU_BLOCK_DIM), LRU_BLOCK_DIM ** -0.5),
        'lru_bx': nrm((nL, 2, D_RNN), 0.02),
        'lru_lam': jnp.log(p) - jnp.log1p(-p),
        'lru_w_out': nrm((nL, D_RNN, D), D_RNN ** -0.5),
        'moe_w_router': nrm((D, N_EXPERTS), D ** -0.5),
        'moe_router_bias': nrm((N_EXPERTS,), 0.01),
        'moe_w1': nrm((DEPTH, N_EXPERTS, D, D_EXPERT), D ** -0.5),
        'moe_w3': nrm((DEPTH, N_EXPERTS, D, D_EXPERT), D ** -0.5),
        'moe_w2': nrm((DEPTH, N_EXPERTS, D_EXPERT, D), D_EXPERT ** -0.5),
    }


def reference(x, c, ctx, c_ctx, w_mod, b_mod, norm_mix, norm_ffn, norm_f,
              conv_pw1, conv_pw1_b, conv_dw, conv_dw_b, conv_ln_g, conv_ln_b, conv_pw2, conv_pw2_b,
              attn_w_qkv, attn_w_o, attn_sink,
              lru_w_in, lru_conv_w, lru_conv_b, lru_wa, lru_ba, lru_wx, lru_bx, lru_lam, lru_w_out,
              moe_w_router, moe_router_bias, moe_w1, moe_w3, moe_w2):
    B, S, _ = x.shape
    L = ctx.shape[1]
    ROWS = S // GRID_W
    rows = jnp.repeat(jnp.arange(ROWS, dtype=jnp.int32), GRID_W)
    cols = jnp.tile(jnp.arange(GRID_W, dtype=jnp.int32), ROWS)
    cos, sin = axial_rope_tables(rows, cols)
    sc = jax.nn.silu(c)
    scc = jax.nn.silu(c_ctx)
    xl, xc = x, ctx
    for i in range(DEPTH):
        last = i == DEPTH - 1
        kind, slot = i % N_MIXERS, i // N_MIXERS
        mod_l = jnp.split((sc @ w_mod[i] + b_mod[i])[:, None, :], N_MOD, axis=-1)
        mod_c = jnp.split(scc @ w_mod[i] + b_mod[i], N_MOD, axis=-1)
        hl = modulate(rmsnorm(xl, norm_mix[i]), mod_l[0], mod_l[1])
        hc = None if (last and kind == 0) else modulate(rmsnorm(xc, norm_mix[i]), mod_c[0], mod_c[1])
        if kind == 0:
            prm = (conv_pw1[slot], conv_pw1_b[slot], conv_dw[slot], conv_dw_b[slot],
                   conv_ln_g[slot], conv_ln_b[slot], conv_pw2[slot], conv_pw2_b[slot])
            yl = conformer_conv(hl, *prm)
            yc = None if last else conformer_conv(hc, *prm)
        elif kind == 1:
            yc, yl = windowed_sink_gqa(hc, hl, attn_w_qkv[slot], attn_w_o[slot], attn_sink[slot], cos, sin)
        else:
            yc, yl = bidir_rglru(hc, hl, lru_w_in[slot], lru_conv_w[slot], lru_conv_b[slot], lru_wa[slot],
                                 lru_ba[slot], lru_wx[slot], lru_bx[slot], lru_lam[slot], lru_w_out[slot])
        xl = xl + mod_l[2] * yl
        moe_prm = (moe_w_router, moe_router_bias, moe_w1[i], moe_w3[i], moe_w2[i])
        hl2 = modulate(rmsnorm(xl, norm_ffn[i]), mod_l[3], mod_l[4])
        if last:
            xl = xl + mod_l[5] * moe(hl2, *moe_prm)
        else:
            xc = xc + mod_c[2] * yc
            hc2 = modulate(rmsnorm(xc, norm_ffn[i]), mod_c[3], mod_c[4])
            y2 = moe(jnp.concatenate([hc2, hl2], axis=1), *moe_prm)
            xc = xc + mod_c[5] * y2[:, :L]
            xl = xl + mod_l[5] * y2[:, L:]
    return rmsnorm(xl, norm_f)
```

```cpp
#include <hip/hip_runtime.h>
#include <cstdio>
#include <cstdint>

#define PROBE_BUF WS_Y
#define PROBE_LD 1024
#define PROBE_TOK 0
#define PROBE_M0 64
#define MOE_FACTOR 1.0f
#define ABL_MASK 0
#define LAS __attribute__((address_space(3)))
#define GAS __attribute__((address_space(1)))
typedef unsigned short bf16;
typedef short bf16x8 __attribute__((ext_vector_type(8)));
typedef short s16x4 __attribute__((ext_vector_type(4)));
typedef float f32x4 __attribute__((ext_vector_type(4)));
typedef float f32x2 __attribute__((ext_vector_type(2)));
typedef unsigned u32x4 __attribute__((ext_vector_type(4)));
typedef unsigned u32x2 __attribute__((ext_vector_type(2)));

constexpr int D = 1024, SEQ = 8192, CTXL = 256;
constexpr int ML = 2 * SEQ, MC = 2 * CTXL, MT = ML + MC;
constexpr int NEXP = 16, DEXP = 512, TCAP = MT;
constexpr int NSLOT = 2 * MT + NEXP * 256;
constexpr int NCHUNK = (SEQ + CTXL) / 64;
constexpr float EPS = 1e-6f;
constexpr int NWAVES = 8, NTHR = 512;
#define NEG_INF (-__builtin_inff())

constexpr size_t MiB = 1u << 20;
constexpr size_t WS_CTL = 0, CTL_ZERO_BYTES = 1 * MiB;
constexpr size_t WS_MODP = 1 * MiB;
constexpr size_t WS_MOD = 4 * MiB;
constexpr size_t WS_WRT = WS_MOD + 512 * 1024;
constexpr size_t WS_ROPE = WS_WRT + 128 * 1024;
constexpr size_t WS_SUMA = 5 * MiB, WS_SUMB = 8 * MiB, WS_CARRY = 11 * MiB;
constexpr size_t WS_TOK = 14 * MiB;
constexpr size_t WS_RINFO = 16 * MiB;
constexpr size_t WS_PW1T = 17 * MiB, WS_PW2T = 25 * MiB, WS_QKVT = 29 * MiB, WS_WOT = 32 * MiB, WS_WINT = 34 * MiB, WS_WOUTT = 38 * MiB, WS_WAXT = 40 * MiB;
constexpr size_t WS_W13T = 41 * MiB, WS_W2T = 169 * MiB;
constexpr size_t WS_X = 233 * MiB;
constexpr size_t WS_H = 299 * MiB;
constexpr size_t WS_U1 = 332 * MiB, WS_U2 = 365 * MiB, WS_G = 398 * MiB, WS_KB = 431 * MiB, WS_VB = 440 * MiB;
constexpr size_t WS_HID = 332 * MiB, WS_Y = 370 * MiB;
constexpr size_t WS_END = 449 * MiB;
static_assert(WS_HID + (size_t)NSLOT * DEXP * 2 <= WS_Y && WS_Y + (size_t)NSLOT * D * 2 <= WS_END, "moe overlay");
static_assert(WS_KB + (size_t)MT * 256 * 2 <= WS_VB && WS_VB + (size_t)MT * 256 * 2 <= WS_END, "kv");
constexpr int CW_BAR = 4096;
constexpr int CW_CNT = 16384;

constexpr int RING_BYTES = 131072;
constexpr int L_SC = RING_BYTES;
constexpr int L_GTAB = RING_BYTES + 12288;
constexpr int L_TST = L_GTAB + 2048;
constexpr int L_MISC = L_TST + 256;
constexpr int L_RT = L_MISC + 64;
constexpr int LDS_BYTES = 151552;

__device__ __forceinline__ unsigned cvt_pk_bf16(float lo, float hi) { unsigned r; asm volatile("v_cvt_pk_bf16_f32 %0, %1, %2" : "=v"(r) : "v"(lo), "v"(hi)); return r; }
__device__ __forceinline__ unsigned f2bf(float f) { unsigned u = __builtin_bit_cast(unsigned, f); return (u + 0x7fffu + ((u >> 16) & 1u)) >> 16; }
__device__ __forceinline__ unsigned pk2(float lo, float hi) { return f2bf(lo) | (f2bf(hi) << 16); }
__device__ __forceinline__ float bf_lo(unsigned u) { return __builtin_bit_cast(float, u << 16); }
__device__ __forceinline__ float bf_hi(unsigned u) { return __builtin_bit_cast(float, u & 0xffff0000u); }
__device__ __forceinline__ float fast_rcp(float x) { return __builtin_amdgcn_rcpf(x); }
__device__ __forceinline__ float sigmoidf_(float x) { return fast_rcp(1.0f + __expf(-x)); }
__device__ __forceinline__ float siluf_(float x) { return x * sigmoidf_(x); }
__device__ __forceinline__ float gelu_tanh(float x) { const float z = 1.5957691216057308f * (x + 0.044715f * x * x * x); return x * sigmoidf_(z); }
__device__ __forceinline__ float wave_sum(float v) {
#pragma unroll
    for (int o = 1; o < 64; o <<= 1) v += __shfl_xor(v, o);
    return v;
}

namespace g8 {
constexpr int BM = 256, BK = 64, HALF = 128, HTB = HALF * BK * 2, STAGE_BYTES = 8 * HTB, NXCD = 8, WGM = 8;
__device__ __forceinline__ int lds_byte(int r, int c) { const int st = (r >> 4) * 2 + (c >> 5), rr = r & 15, cc = c & 31, ob = rr * 64 + cc * 2; return st * 1024 + (ob ^ (((ob >> 9) & 1) << 5)); }
__device__ __forceinline__ void stage_rc(int b, int& R, int& C) { const int st = b / 1024, sb = b % 1024, swz = sb ^ (((sb >> 9) & 1) << 5); R = (st >> 1) * 16 + swz / 64; C = (st & 1) * 32 + (swz % 64) / 2; }
__device__ __forceinline__ int perm32(int rho) { const int n = rho >> 4, i = rho & 15; return 8 * (i >> 2) + 4 * n + (i & 3); }

struct Unit { const char* A; const char* B; int pm, pn, aux; };

__device__ __forceinline__ int xcd_remap(int L, int nwg) { const int q = nwg / NXCD, r = nwg % NXCD, xcd = L % NXCD, off = L / NXCD; return (xcd < r ? xcd * (q + 1) : r * (q + 1) + (xcd - r) * q) + off; }

template <int K, bool GATHER, class Epi, class Sched>
__device__ __forceinline__ void gemm_phase(LAS unsigned char* lds, LAS unsigned* gtab, const Sched& S, const Epi& E) {
    int tid_ = threadIdx.x; asm volatile("" : "+v"(tid_));
    const int tid = tid_, wid = __builtin_amdgcn_readfirstlane(tid >> 6), lane = tid & 63, wr = wid >> 2, wc = wid & 3, fr = lane & 15, fq = lane >> 4;
    constexpr int nt = K / BK;
    unsigned voffB[2], vA[2][2]; int Rrow[2]; unsigned Coff[2];
    constexpr size_t kstep = (size_t)(BK * 2);
    constexpr size_t hstep = (size_t)HALF * K * 2;
#pragma unroll
    for (int i = 0; i < 2; ++i) { int R, C; stage_rc(tid * 16 + i * 8192, R, C); const int Rb = Epi::PERM ? ((R & ~31) + perm32(R & 31)) : R;
        voffB[i] = (unsigned)(Rb * K + C) * 2u; Rrow[i] = R; Coff[i] = (unsigned)C * 2u;
        vA[0][i] = (unsigned)(R * K + C) * 2u; vA[1][i] = (unsigned)((R + HALF) * K + C) * 2u; }
    const unsigned ldsw = (unsigned)wid * 1024u;
    const int aoff = lds_byte(wr * 64 + fr, fq * 8), boff = lds_byte(wc * 32 + fr, fq * 8);
#define G8_SA(b, h) (((b) * 2 + (h)) * HTB)
#define G8_SB(b, h) ((4 + (b) * 2 + (h)) * HTB)
#define G8_STAGE(bufoff, gbase, voff) do { _Pragma("unroll") for (int _i = 0; _i < 2; ++_i) \
        __builtin_amdgcn_global_load_lds((const unsigned*)((const char*)(gbase) + (voff)[_i]), (LAS unsigned*)(lds + (bufoff) + ldsw + _i * 8192), 16, 0, 0); } while (0)
#define G8_LDA(dst, b, h) do { _Pragma("unroll") for (int m = 0; m < 4; ++m) _Pragma("unroll") for (int k = 0; k < 2; ++k) dst[m][k] = *(const LAS bf16x8*)(lds + G8_SA(b, h) + aoff + m * 2048 + k * 1024); } while (0)
#define G8_LDB(dst, b, h) do { _Pragma("unroll") for (int n = 0; n < 2; ++n) _Pragma("unroll") for (int k = 0; k < 2; ++k) dst[n][k] = *(const LAS bf16x8*)(lds + G8_SB(b, h) + boff + n * 2048 + k * 1024); } while (0)
#define G8_MMA(ai, bj, At, Bt) do { __builtin_amdgcn_s_setprio(1); _Pragma("unroll") for (int m = 0; m < 4; ++m) _Pragma("unroll") for (int n = 0; n < 2; ++n) _Pragma("unroll") for (int k = 0; k < 2; ++k) \
        acc[ai][bj][m][n] = __builtin_amdgcn_mfma_f32_16x16x32_bf16(Bt[n][k], At[m][k], acc[ai][bj][m][n], 0, 0, 0); __builtin_amdgcn_s_setprio(0); } while (0)
#define G8_WAIT_V(n) asm volatile("s_waitcnt vmcnt(" #n ")" ::: "memory")
#define G8_WAIT_L(n) asm volatile("s_waitcnt lgkmcnt(" #n ")" ::: "memory")
#define G8_BAR __builtin_amdgcn_s_barrier()
#define G8_SCHED __builtin_amdgcn_sched_barrier(0)
    Unit cur, nxt; int ui = 0;
    if (!S.next(0, cur)) return;
    if constexpr (GATHER) {
        if (tid < 256) gtab[tid] = S.rowoff(cur, tid);
        G8_WAIT_L(0); G8_BAR; asm volatile("" ::: "memory");
#pragma unroll
        for (int h = 0; h < 2; ++h)
#pragma unroll
            for (int i = 0; i < 2; ++i) vA[h][i] = gtab[h * HALF + Rrow[i]] + Coff[i];
    }
    f32x4 acc[2][2][4][2];
#pragma unroll
    for (int a = 0; a < 2; ++a)
#pragma unroll
        for (int b = 0; b < 2; ++b)
#pragma unroll
            for (int m = 0; m < 4; ++m)
#pragma unroll
                for (int n = 0; n < 2; ++n) acc[a][b][m][n] = (f32x4){0.f, 0.f, 0.f, 0.f};
    bf16x8 At[4][2], B0[2][2], B1[2][2];
    const char* cA = cur.A; const char* cB = cur.B;
    G8_STAGE(G8_SB(0, 0), cB, voffB); G8_STAGE(G8_SB(0, 1), cB + hstep, voffB); G8_STAGE(G8_SA(0, 0), cA, vA[0]); G8_STAGE(G8_SA(0, 1), cA, vA[1]);
    if (wr == 1) G8_BAR;
    G8_WAIT_V(2); G8_BAR;
    G8_STAGE(G8_SB(1, 0), cB + kstep, voffB); G8_STAGE(G8_SA(1, 0), cA + kstep, vA[0]); G8_STAGE(G8_SB(1, 1), cB + hstep + kstep, voffB);
    G8_WAIT_V(6); G8_BAR;
    for (;;) {
        const bool has_next = S.next(ui + 1, nxt);
        if constexpr (GATHER) { if (has_next && tid < 256) gtab[((ui + 1) & 1) * 256 + tid] = S.rowoff(nxt, tid); }
        const char* nA = has_next ? nxt.A : cA; const char* nB = has_next ? nxt.B : cB;
#pragma nounroll
        for (int t = 0; t < nt; t += 2) {
            const bool last = (t == nt - 2);
            const char* a1 = cA + (size_t)(t + 1) * kstep;
            const char* a2 = last ? nA : cA + (size_t)(t + 2) * kstep; const char* b2 = last ? nB : cB + (size_t)(t + 2) * kstep;
            const char* a3 = a2 + kstep; const char* b3 = b2 + kstep;
            G8_LDB(B0, 0, 0); G8_LDB(B1, 0, 1); G8_SCHED; G8_LDA(At, 0, 0); G8_STAGE(G8_SA(1, 1), a1, vA[1]);
            if constexpr (GATHER) { if (last && has_next) {
#pragma unroll
                for (int h = 0; h < 2; ++h)
#pragma unroll
                    for (int i = 0; i < 2; ++i) vA[h][i] = gtab[((ui + 1) & 1) * 256 + h * HALF + Rrow[i]] + Coff[i]; } }
            G8_WAIT_V(8); G8_WAIT_L(0); G8_BAR; G8_MMA(0, 0, At, B0); G8_MMA(0, 1, At, B1); G8_BAR; G8_SCHED;
            G8_LDA(At, 0, 1); G8_STAGE(G8_SB(0, 0), b2, voffB); G8_STAGE(G8_SB(0, 1), b2 + hstep, voffB); G8_STAGE(G8_SA(0, 0), a2, vA[0]);
            G8_WAIT_V(8); G8_WAIT_L(0); G8_BAR; G8_MMA(1, 0, At, B0); G8_MMA(1, 1, At, B1); G8_BAR; G8_SCHED;
            G8_LDB(B0, 1, 0); G8_LDB(B1, 1, 1); G8_SCHED; G8_LDA(At, 1, 0); G8_STAGE(G8_SA(0, 1), a2, vA[1]);
            G8_WAIT_V(8); G8_WAIT_L(0); G8_BAR; G8_MMA(0, 0, At, B0); G8_MMA(0, 1, At, B1); G8_BAR; G8_SCHED;
            G8_LDA(At, 1, 1); G8_STAGE(G8_SB(1, 0), b3, voffB); G8_STAGE(G8_SB(1, 1), b3 + hstep, voffB); G8_STAGE(G8_SA(1, 0), a3, vA[0]);
            G8_WAIT_V(8); G8_WAIT_L(0); G8_BAR; G8_MMA(1, 0, At, B0); G8_MMA(1, 1, At, B1); G8_BAR; G8_SCHED;
        }
        if (wr == 0) G8_BAR;
        E(acc, cur, wr, wc, fr, fq);
        if (!has_next) break;
#pragma unroll
        for (int a = 0; a < 2; ++a)
#pragma unroll
            for (int b = 0; b < 2; ++b)
#pragma unroll
                for (int m = 0; m < 4; ++m)
#pragma unroll
                    for (int n = 0; n < 2; ++n) acc[a][b][m][n] = (f32x4){0.f, 0.f, 0.f, 0.f};
        cur = nxt; cA = nA; cB = nB; ++ui;
        if (wr == 1) G8_BAR;
    }
    G8_WAIT_V(0);
    G8_BAR;
#undef G8_SA
#undef G8_SB
#undef G8_STAGE
#undef G8_LDA
#undef G8_LDB
#undef G8_MMA
#undef G8_WAIT_V
#undef G8_WAIT_L
#undef G8_BAR
#undef G8_SCHED
}
}

#define XB_TMO      128
#define XB_XCNT(j)  (256  + 64 * (j))
#define XB_XSUB(j)  (1280 + 64 * (j))
#define XB_XGEN(j)  (2304 + 64 * (j))
#define XB_TOP      3328
#define XB_TOPGEN   3392
#define XCD_BAR_WORDS 3456
#define XB_SPIN_CAP (1u << 18)
__device__ __forceinline__ unsigned xb_ld(unsigned* p)              { return __hip_atomic_load(p, __ATOMIC_RELAXED, __HIP_MEMORY_SCOPE_AGENT); }
__device__ __forceinline__ unsigned xb_add(unsigned* p, unsigned v) { return __hip_atomic_fetch_add(p, v, __ATOMIC_RELAXED, __HIP_MEMORY_SCOPE_AGENT); }
__device__ __forceinline__ unsigned xb_xcc_id() { return (unsigned)__builtin_amdgcn_s_getreg((3 << 11) | 20) & 0xFu; }
#define XB_SPIN(cond, bar) do { unsigned _sp = 0; while (cond) { __builtin_amdgcn_s_sleep(1); \
    if ((++_sp & 255u) == 0u) { if (xb_ld(&(bar)[XB_TMO])) break; if (_sp > XB_SPIN_CAP) { atomicAdd(&(bar)[XB_TMO], 1u); break; } } } } while (0)
struct XcdBarrier { unsigned* bar; unsigned x; volatile LAS unsigned* st; };
__device__ __forceinline__ XcdBarrier xcd_barrier_post(unsigned* bar, volatile LAS unsigned* st) {
    XcdBarrier b; b.bar = bar; b.x = xb_xcc_id(); b.st = st;
    if (threadIdx.x == 0) (void)xb_add(&bar[XB_XCNT(b.x)], 1u);
    return b;
}
__device__ __forceinline__ void xcd_barrier_complete(unsigned* bar, unsigned x, unsigned& nloc, unsigned& nx) {
    const unsigned G = gridDim.x * gridDim.y * gridDim.z;
    unsigned sum, cnt, mine, sp = 0u;
    for (;;) {
        sum = 0u; cnt = 0u; mine = 0u;
#pragma unroll
        for (unsigned j = 0; j < 16; ++j) { const unsigned c = xb_ld(&bar[XB_XCNT(j)]); sum += c; cnt += (c > 0u) ? 1u : 0u; mine = (j == x) ? c : mine; }
        if (sum == G) break;
        __builtin_amdgcn_s_sleep(1);
        if ((++sp & 255u) == 0u) { if (xb_ld(&bar[XB_TMO])) break; if (sp > XB_SPIN_CAP) { atomicAdd(&bar[XB_TMO], 1u); break; } }
    }
    nloc = mine > 0u ? mine : 1u; nx = cnt > 0u ? cnt : 1u;
}
__device__ __forceinline__ void xcd_barrier(const XcdBarrier& b) {
    asm volatile("s_waitcnt vmcnt(0)" ::: "memory");
    __syncthreads();
    if (threadIdx.x == 0) {
        unsigned* bar = b.bar;
        __builtin_amdgcn_s_waitcnt(0);
        unsigned nloc = b.st[0], nx = b.st[1];
        if (nloc == 0u) { xcd_barrier_complete(bar, b.x, nloc, nx); b.st[0] = nloc; b.st[1] = nx; }
        const unsigned old = xb_add(&bar[XB_XSUB(b.x)], 1u);
        const unsigned gen = old / nloc;
        if (old + 1u == (gen + 1u) * nloc) {
            __builtin_amdgcn_fence(__ATOMIC_RELEASE, "agent");
            asm volatile("s_waitcnt vmcnt(0)" ::: "memory");
            const unsigned og = xb_add(&bar[XB_TOP], 1u);
            const unsigned tg = og / nx;
            if (og + 1u == (tg + 1u) * nx) xb_add(&bar[XB_TOPGEN], 1u);
            else XB_SPIN(xb_ld(&bar[XB_TOPGEN]) == tg, bar);
            __builtin_amdgcn_fence(__ATOMIC_ACQUIRE, "agent");
            xb_add(&bar[XB_XGEN(b.x)], 1u);
            asm volatile("s_waitcnt vmcnt(0)" ::: "memory");
        } else {
            XB_SPIN(xb_ld(&bar[XB_XGEN(b.x)]) == gen, bar);
            __builtin_amdgcn_fence(__ATOMIC_ACQUIRE, "agent");
            asm volatile("s_waitcnt vmcnt(0)" ::: "memory");
        }
    }
    __syncthreads();
}

struct Params { const float* in[34]; float* out; unsigned char* ws; };
enum { I_X = 0, I_C, I_CTX, I_CCTX, I_WMOD, I_BMOD, I_NMIX, I_NFFN, I_NF, I_PW1, I_PW1B, I_DW, I_DWB, I_LNG, I_LNB, I_PW2, I_PW2B, I_QKV, I_WO, I_SINK,
       I_WIN, I_LCW, I_LCB, I_WA, I_BA, I_WX, I_BX, I_LAM, I_WOUT, I_WR, I_RB, I_W1, I_W3, I_W2 };

struct Frame {
    LAS unsigned char* lds;
    int tid, lane, wave, G, bx;
    const float* const* in; float* out; unsigned char* ws; int z;
};
__device__ __forceinline__ Frame phase_frame(const Frame& F0) {
    Frame F = F0; int t = threadIdx.x; asm volatile("" : "+v"(t)); int z = 0; asm volatile("" : "+s"(z));
    F.tid = t; F.lane = t & 63; F.wave = __builtin_amdgcn_readfirstlane(t >> 6); F.z = z; return F;
}
#define WSP(T, off) ((T*)(F.ws + (off)))
__device__ __forceinline__ int bsel_row(int m) { return m < SEQ ? 0 : (m < ML ? 1 : 2); }
__device__ __forceinline__ const float* xin_row(const Frame& F, bool from_input, int m) {
    if (from_input) return m < ML ? F.in[I_X + F.z] + (size_t)m * D : F.in[I_CTX + F.z] + (size_t)(m - ML) * D;
    return WSP(const float, WS_X) + (size_t)m * D;
}
__device__ __forceinline__ const float* mod_vec(const Frame& F, int layer, int bs, int which) { return WSP(const float, WS_MOD) + ((size_t)(layer * 3 + bs) * 6 + which) * D; }

struct DenseSched {
    const char* A; const char* B; size_t aT, bT; int nM, nN, nwg, G, c;
    __device__ __forceinline__ void init(const void* A_, const void* B_, int K, int nM_, int nN_, int G_, int c_) { A = (const char*)A_; B = (const char*)B_; aT = (size_t)256 * K * 2; bT = aT; nM = nM_; nN = nN_; nwg = nM * nN; G = G_; c = c_; }
    __device__ __forceinline__ bool next(int i, g8::Unit& u) const {
        const int L = i * G + c; if (L >= nwg) return false;
        const int wgid = g8::xcd_remap(L, nwg);
        const int nig = g8::WGM * nN, gid = wgid / nig, fm = gid * g8::WGM, gsz = (nM - fm) < g8::WGM ? (nM - fm) : g8::WGM;
        u.pm = fm + ((wgid % nig) % gsz); u.pn = (wgid % nig) / gsz; u.aux = 0;
        u.A = A + (size_t)u.pm * aT; u.B = B + (size_t)u.pn * bT; return true;
    }
    __device__ __forceinline__ unsigned rowoff(const g8::Unit&, int) const { return 0u; }
};
struct MoeSched {
    const char* A; const char* B; size_t aT, bE, bT; int G, c; const LAS int* tst; const int* tok; bool gather;
    __device__ __forceinline__ bool next(int i, g8::Unit& u) const {
        const int total = tst[16] * 4; const int L = i * G + c; if (L >= total) return false;
        const int id = g8::xcd_remap(L, total);
        const int g = id >> 2, pn = id & 3; int e = 0;
#pragma unroll
        for (int k = 1; k < 16; ++k) e += (g >= tst[k]) ? 1 : 0;
        u.pm = g; u.pn = pn; u.aux = e | ((g - tst[e]) << 8);
        u.A = gather ? A : A + (size_t)g * aT; u.B = B + (size_t)e * bE + (size_t)pn * bT; return true;
    }
    __device__ __forceinline__ unsigned rowoff(const g8::Unit& u, int r) const {
        const int e = u.aux & 255, j = u.aux >> 8; int pos = j * 256 + r; const int cnt = tst[32 + e]; pos = pos < cnt ? pos : 0;
        return (unsigned)tok[e * TCAP + pos] * (unsigned)(D * 2);
    }
};

template <int MODE  > struct EpiGlu {
    static constexpr bool PERM = true;
    bf16* O; int ldo; const float* bias;
    __device__ __forceinline__ void operator()(const f32x4 (&acc)[2][2][4][2], const g8::Unit& u, int wr, int wc, int fr, int fq) const {
        const int row0 = u.pm * 256 + wr * 64 + fr, col0 = u.pn * 128 + wc * 32 + 8 * fq;
        f32x4 ba[2], bg[2];
#pragma unroll
        for (int n = 0; n < 2; ++n) { ba[n] = bias ? *(const f32x4*)(bias + col0 + 4 * n) : (f32x4){0.f, 0.f, 0.f, 0.f}; bg[n] = bias ? *(const f32x4*)(bias + 1024 + col0 + 4 * n) : (f32x4){0.f, 0.f, 0.f, 0.f}; }
#pragma unroll
        for (int ai = 0; ai < 2; ++ai)
#pragma unroll
            for (int m = 0; m < 4; ++m) {
                float o[8];
#pragma unroll
                for (int n = 0; n < 2; ++n)
#pragma unroll
                    for (int j = 0; j < 4; ++j) { const float a = acc[ai][0][m][n][j] + ba[n][j], g = acc[ai][1][m][n][j] + bg[n][j];
                        o[4 * n + j] = MODE == 0 ? a * sigmoidf_(g) : siluf_(a) * g; }
                u32x4 w; w.x = cvt_pk_bf16(o[0], o[1]); w.y = cvt_pk_bf16(o[2], o[3]); w.z = cvt_pk_bf16(o[4], o[5]); w.w = cvt_pk_bf16(o[6], o[7]);
                *(u32x4*)(O + (size_t)(row0 + ai * 128 + m * 16) * ldo + col0) = w;
            }
    }
};
struct EpiBf16 {
    static constexpr bool PERM = true;
    bf16* O0; bf16* O1; int split; int ldo;
    __device__ __forceinline__ void operator()(const f32x4 (&acc)[2][2][4][2], const g8::Unit& u, int wr, int wc, int fr, int fq) const {
        const bool hi = u.pn >= split; bf16* O = hi ? O1 : O0; const int pn = hi ? u.pn - split : u.pn;
        const int row0 = u.pm * 256 + wr * 64 + fr, col0 = pn * 256 + wc * 32 + 8 * fq;
#pragma unroll
        for (int ai = 0; ai < 2; ++ai)
#pragma unroll
            for (int m = 0; m < 4; ++m)
#pragma unroll
                for (int bj = 0; bj < 2; ++bj) {
                    f32x4 v0 = acc[ai][bj][m][0], v1 = acc[ai][bj][m][1];
                    if (hi) {
#pragma unroll
                        for (int j = 0; j < 4; ++j) { v0[j] = gelu_tanh(v0[j]); v1[j] = gelu_tanh(v1[j]); } }
                    u32x4 w; w.x = cvt_pk_bf16(v0[0], v0[1]); w.y = cvt_pk_bf16(v0[2], v0[3]); w.z = cvt_pk_bf16(v1[0], v1[1]); w.w = cvt_pk_bf16(v1[2], v1[3]);
                    *(u32x4*)(O + (size_t)(row0 + ai * 128 + m * 16) * ldo + col0 + bj * 128) = w;
                }
    }
};
struct EpiRes {
    static constexpr bool PERM = false;
    const float* xl; const float* xc;
    float* X; const float* bias; const float* gate; float gscale;
    __device__ __forceinline__ void operator()(const f32x4 (&acc)[2][2][4][2], const g8::Unit& u, int wr, int wc, int fr, int fq) const {
        const int bs = u.pm < 32 ? 0 : (u.pm < 64 ? 1 : 2);
        const float* xin = u.pm < 64 ? xl : xc - (size_t)ML * D;
        const float* gt = gate + (size_t)bs * 6 * D;
        const int row0 = u.pm * 256 + wr * 64 + fr, col0 = u.pn * 256 + wc * 32 + 4 * fq;
#pragma unroll
        for (int bj = 0; bj < 2; ++bj)
#pragma unroll
            for (int n = 0; n < 2; ++n) {
                const int co = col0 + bj * 128 + n * 16;
                const f32x4 bv = bias ? *(const f32x4*)(bias + co) : (f32x4){0.f, 0.f, 0.f, 0.f}; const f32x4 gv = *(const f32x4*)(gt + co) * gscale;
#pragma unroll
                for (int ai = 0; ai < 2; ++ai) {
                    f32x4 xi[4];
#pragma unroll
                    for (int m = 0; m < 4; ++m) xi[m] = *(const f32x4*)(xin + (size_t)(row0 + ai * 128 + m * 16) * D + co);
#pragma unroll
                    for (int m = 0; m < 4; ++m) *(f32x4*)(X + (size_t)(row0 + ai * 128 + m * 16) * D + co) = xi[m] + gv * (acc[ai][bj][m][n] + bv);
                    asm volatile("" ::: "memory");
                }
            }
    }
};
struct EpiQkv {
    static constexpr bool PERM = false;
    bf16* Q; bf16* Kb; bf16* Vb; const float* rope;
    __device__ __forceinline__ void operator()(const f32x4 (&acc)[2][2][4][2], const g8::Unit& u, int wr, int wc, int fr, int fq) const {
        const int row0 = u.pm * 256 + wr * 64 + fr;
        bf16* O; int ldo, colb; float sc;
        if (u.pn < 4) { O = Q; ldo = D; colb = u.pn * 256; sc = 0.125f; } else if (u.pn == 4) { O = Kb; ldo = 256; colb = 0; sc = 1.f; } else { O = Vb; ldo = 256; colb = 0; sc = 1.f; }
        const bool do_rope = (u.pn < 5) && (u.pm < 64);
        const int axis = wc & 1;
#pragma unroll
        for (int ai = 0; ai < 2; ++ai)
#pragma unroll
            for (int m = 0; m < 4; ++m) {
                const int row = row0 + ai * 128 + m * 16;
                f32x4 cs = {1.f, 1.f, 1.f, 1.f}, sn = {0.f, 0.f, 0.f, 0.f};
                if (do_rope) { const int t = row & (SEQ - 1); const int pos = axis ? (t & 63) : (t >> 6); cs = *(const f32x4*)(rope + pos * 16 + 4 * fq); sn = *(const f32x4*)(rope + 2048 + pos * 16 + 4 * fq); }
#pragma unroll
                for (int bj = 0; bj < 2; ++bj) {
                    const f32x4 x0 = acc[ai][bj][m][0] * sc, x1 = acc[ai][bj][m][1] * sc;
                    const f32x4 o0 = x0 * cs - x1 * sn, o1 = x1 * cs + x0 * sn;
                    bf16* p = O + (size_t)row * ldo + colb + bj * 128 + wc * 32 + 4 * fq;
                    u32x2 w0, w1; w0.x = cvt_pk_bf16(o0[0], o0[1]); w0.y = cvt_pk_bf16(o0[2], o0[3]); w1.x = cvt_pk_bf16(o1[0], o1[1]); w1.y = cvt_pk_bf16(o1[2], o1[3]);
                    *(u32x2*)p = w0; *(u32x2*)(p + 16) = w1;
                }
            }
    }
};

__device__ const double ROPE_INV[16] = {1.0, 0.56234132519034907, 0.31622776601683794, 0.17782794100389229, 0.1, 0.056234132519034911, 0.031622776601683791, 0.017782794100389229,
                                        0.01, 0.005623413251903491, 0.0031622776601683794, 0.0017782794100389228, 0.001, 0.0005623413251903491, 0.00031622776601683794, 0.00017782794100389227};

__device__ __forceinline__ void transpose_item(const float* W, int ldw, int k0, int sn0, bf16* WT, int ldk, int dn0, LAS float* scr, int lane) {
#pragma unroll 16
    for (int i = 0; i < 32; ++i) { const int kk = 2 * i + (lane >> 5); scr[kk * 33 + (lane & 31)] = W[(size_t)(k0 + kk) * ldw + sn0 + (lane & 31)]; }
    asm volatile("s_waitcnt lgkmcnt(0)" ::: "memory");
    const int c = lane & 7;
#pragma unroll
    for (int j = 0; j < 4; ++j) { const int n = (lane >> 3) + 8 * j; const LAS float* s = scr + (8 * c) * 33 + n;
        u32x4 o; o.x = pk2(s[0 * 33], s[1 * 33]); o.y = pk2(s[2 * 33], s[3 * 33]); o.z = pk2(s[4 * 33], s[5 * 33]); o.w = pk2(s[6 * 33], s[7 * 33]);
        *(u32x4*)(WT + (size_t)(dn0 + n) * ldk + k0 + 8 * c) = o; }
    asm volatile("s_waitcnt lgkmcnt(0)" ::: "memory");
}
__device__ __forceinline__ int map_col(int mode, int n) {
    if (mode == 0) return n;
    if (mode == 1) return n < 1024 ? (n >> 7) * 256 + (n & 127) : ((n - 1024) >> 7) * 256 + 128 + (n & 127);
    if (mode == 2) return (n >> 7) * 256 + (n & 127);
    return (n >> 7) * 256 + 128 + (n & 127);
}

__device__ __forceinline__ void p0a_phase(const Frame& F0) {
    const Frame F = phase_frame(F0);
    LAS float* sc = (LAS float*)(F.lds + L_SC);
    for (int i = F.tid; i < 3 * D; i += NTHR) { const int r = i >> 10, k = i & 1023; const float v = r < 2 ? F.in[I_C + F.z][r * D + k] : F.in[I_CCTX + F.z][k]; sc[i] = v / (1.0f + expf(-v)); }
    __syncthreads();
    LAS float* scr = (LAS float*)(F.lds + F.wave * 16384);
    const int gw = F.bx * NWAVES + F.wave, NGW = F.G * NWAVES, lane = F.lane;
    constexpr int NMODI = 4 * 96 * 8;
    for (int it = gw; it < NMODI; it += NGW) {
        const int i = it / 768, rem = it % 768, cg = rem >> 3, kc = rem & 7;
        const int n = cg * 64 + lane; const float* w = F.in[I_WMOD + F.z] + ((size_t)i * D + kc * 128) * 6144 + n;
        float a0 = 0.f, a1 = 0.f, a2 = 0.f;
#pragma unroll 16
        for (int k = 0; k < 128; ++k) { const float wv = w[(size_t)k * 6144]; a0 += wv * sc[kc * 128 + k]; a1 += wv * sc[D + kc * 128 + k]; a2 += wv * sc[2 * D + kc * 128 + k]; }
        float* mp = WSP(float, WS_MODP) + ((size_t)(kc * 4 + i) * 3) * 6144 + n;
        mp[0] = a0; mp[6144] = a1; mp[2 * 6144] = a2;
    }
    constexpr int per_pw1 = 16 * 64, per_sq = 16 * 32, per_qkv = 16 * 48, per_ax = 2 * 4, per_w13 = 16 * 16, per_w2 = 8 * 32;
    constexpr int NT = 2 * per_pw1 + 2 * per_sq + per_qkv + per_sq + per_pw1 + per_sq + 32 * per_ax + 128 * per_w13 + 64 * per_w2;
#define TG(SRC, DSTOFF, K_, N_, NMAT, SSTR, DSTR, MAP) { constexpr int per = ((K_) / 64) * ((N_) / 32); constexpr int tot = per * (NMAT); \
        if (r < tot) { const int mat = r / per, q = r % per, kb = q / ((N_) / 32), nb = q % ((N_) / 32); \
            transpose_item((SRC) + (size_t)mat * (SSTR), (N_), kb * 64, nb * 32, WSP(bf16, DSTOFF) + (size_t)mat * (DSTR), (K_), map_col((MAP), nb * 32), scr, lane); continue; } r -= tot; }
    for (int it = gw; it < NT; it += NGW) {
        int r = it;
        TG(F.in[I_PW1 + F.z], WS_PW1T, 1024, 2048, 2, 1024 * 2048, 2048 * 1024, 1)
        TG(F.in[I_PW2 + F.z], WS_PW2T, 1024, 1024, 2, 1024 * 1024, 1024 * 1024, 0)
        TG(F.in[I_QKV + F.z], WS_QKVT, 1024, 1536, 1, 0, 0, 0)
        TG(F.in[I_WO + F.z], WS_WOT, 1024, 1024, 1, 0, 0, 0)
        TG(F.in[I_WIN + F.z], WS_WINT, 1024, 2048, 1, 0, 0, 0)
        TG(F.in[I_WOUT + F.z], WS_WOUTT, 1024, 1024, 1, 0, 0, 0)
        TG(F.in[I_WA + F.z], WS_WAXT, 128, 128, 16, 16384, 32768, 0)
        TG(F.in[I_WX + F.z], WS_WAXT + 32768, 128, 128, 16, 16384, 32768, 0)
        TG(F.in[I_W1 + F.z], WS_W13T, 1024, 512, 64, 1024 * 512, 1024 * 1024, 2)
        TG(F.in[I_W3 + F.z], WS_W13T, 1024, 512, 64, 1024 * 512, 1024 * 1024, 3)
        TG(F.in[I_W2 + F.z], WS_W2T, 512, 1024, 64, 512 * 1024, 1024 * 512, 0)
    }
#undef TG
}

__device__ __forceinline__ void p0b_phase(const Frame& F0) {
    const Frame F = phase_frame(F0);
    const int gt = F.bx * NTHR + F.tid, NG = F.G * NTHR;
    for (int idx = gt; idx < 4 * 3 * 6144; idx += NG) {
        const int i = idx / 18432, r = (idx / 6144) % 3, n = idx % 6144;
        float v = F.in[I_BMOD + F.z][i * 6144 + n];
#pragma unroll
        for (int kc = 0; kc < 8; ++kc) v += WSP(const float, WS_MODP)[((size_t)(kc * 4 + i) * 3 + r) * 6144 + n];
        WSP(float, WS_MOD)[idx] = v;
    }
    for (int idx = gt; idx < NEXP * D; idx += NG) { const int e = idx >> 10, k = idx & 1023; WSP(float, WS_WRT)[idx] = F.in[I_WR + F.z][k * NEXP + e]; }
    for (int idx = gt; idx < 2048; idx += NG) {
        const int pos = idx >> 4, p = idx & 15;
        const double ang = (double)pos * ROPE_INV[p];
        const double nq = __builtin_rint(ang * 0.63661977236758134308); const double r = ang - nq * 1.57079632679489661923; const int q = ((int)nq) & 3;
        const double r2 = r * r;
        const double sr = r * (1.0 + r2 * (-1.0 / 6 + r2 * (1.0 / 120 + r2 * (-1.0 / 5040 + r2 * (1.0 / 362880 + r2 * (-1.0 / 39916800 + r2 * (1.0 / 6227020800.0)))))));
        const double cr = 1.0 + r2 * (-0.5 + r2 * (1.0 / 24 + r2 * (-1.0 / 720 + r2 * (1.0 / 40320 + r2 * (-1.0 / 3628800 + r2 * (1.0 / 479001600.0))))));
        const double cv = q == 0 ? cr : (q == 1 ? -sr : (q == 2 ? -cr : sr)), sv = q == 0 ? sr : (q == 1 ? cr : (q == 2 ? -sr : -cr));
        WSP(float, WS_ROPE)[idx] = (float)cv; WSP(float, WS_ROPE)[2048 + idx] = (float)sv;
    }
}

__device__ __forceinline__ void norm_phase(const Frame& F0, bool from_input, int layer, int Mrows) {
    const Frame F = phase_frame(F0);
    const int gw = F.bx * NWAVES + F.wave, NGW = F.G * NWAVES, lane = F.lane;
    const f32x4* gn = (const f32x4*)(F.in[I_NMIX + F.z] + layer * D) + lane;
    for (int m = gw; m < Mrows; m += NGW) {
        const f32x4* xr = (const f32x4*)xin_row(F, from_input, m) + lane;
        f32x4 v[4]; float s = 0.f;
#pragma unroll
        for (int j = 0; j < 4; ++j) { v[j] = xr[64 * j]; s += (v[j].x * v[j].x + v[j].y * v[j].y) + (v[j].z * v[j].z + v[j].w * v[j].w); }
        const float rstd = 1.0f / sqrtf(wave_sum(s) * (1.0f / D) + EPS);
        const int bs = bsel_row(m);
        const f32x4* sh = (const f32x4*)mod_vec(F, layer, bs, 0) + lane; const f32x4* sc = (const f32x4*)mod_vec(F, layer, bs, 1) + lane;
        u32x2* o = (u32x2*)(WSP(bf16, WS_H) + (size_t)m * D) + lane;
#pragma unroll
        for (int j = 0; j < 4; ++j) { const f32x4 h = v[j] * rstd * gn[64 * j] * (sc[64 * j] + 1.0f) + sh[64 * j]; u32x2 w; w.x = cvt_pk_bf16(h.x, h.y); w.y = cvt_pk_bf16(h.z, h.w); o[64 * j] = w; }
    }
}

__device__ __forceinline__ void dw_phase(const Frame& F0, int slot, int Mrows, const bf16* U, bf16* V) {
    const Frame F = phase_frame(F0);
    LAS float* tile = (LAS float*)F.lds;
    const int ch = 2 * F.tid, lane = F.lane;
    f32x2 w[31];
#pragma unroll
    for (int k = 0; k < 31; ++k) w[k] = *(const f32x2*)(F.in[I_DW + F.z] + ((size_t)slot * 31 + k) * D + ch);
    const f32x2 bia = *(const f32x2*)(F.in[I_DWB + F.z] + slot * D + ch);
    const int nunits = Mrows / 16;
    for (int u = F.bx; u < nunits; u += F.G) {
        const int m0 = u * 16; int lo, hi;
        if (m0 < ML) { lo = (m0 / SEQ) * SEQ; hi = lo + SEQ; } else { lo = ML + ((m0 - ML) / CTXL) * CTXL; hi = lo + CTXL; }
        f32x2 acc[16];
#pragma unroll
        for (int o = 0; o < 16; ++o) acc[o] = bia;
#pragma unroll
        for (int r = 0; r < 46; ++r) {
            const int row = m0 - 15 + r;
            f32x2 x = {0.f, 0.f};
            if (row >= lo && row < hi) { const unsigned p = *(const unsigned*)(U + (size_t)row * D + ch); x.x = bf_lo(p); x.y = bf_hi(p); }
#pragma unroll
            for (int o = 0; o < 16; ++o) { const int k = r - o; if (k >= 0 && k < 31) acc[o] += w[k] * x; }
        }
#pragma unroll
        for (int o = 0; o < 16; ++o) *(LAS f32x2*)(tile + o * D + ch) = acc[o];
        __syncthreads();
#pragma unroll
        for (int t2 = 0; t2 < 2; ++t2) {
            const int o = F.wave * 2 + t2;
            f32x4 v[4]; float s = 0.f;
#pragma unroll
            for (int j = 0; j < 4; ++j) { v[j] = *(const LAS f32x4*)(tile + o * D + 4 * lane + 256 * j); s += (v[j].x + v[j].y) + (v[j].z + v[j].w); }
            const float mu = wave_sum(s) * (1.0f / D); float q = 0.f;
#pragma unroll
            for (int j = 0; j < 4; ++j) { v[j] = v[j] - mu; q += (v[j].x * v[j].x + v[j].y * v[j].y) + (v[j].z * v[j].z + v[j].w * v[j].w); }
            const float rstd = 1.0f / sqrtf(wave_sum(q) * (1.0f / D) + EPS);
            const f32x4* lg = (const f32x4*)(F.in[I_LNG + F.z] + slot * D) + lane; const f32x4* lb = (const f32x4*)(F.in[I_LNB + F.z] + slot * D) + lane;
            u32x2* op = (u32x2*)(V + (size_t)(m0 + o) * D) + lane;
#pragma unroll
            for (int j = 0; j < 4; ++j) { f32x4 y = v[j] * rstd * lg[64 * j] + lb[64 * j]; y.x = siluf_(y.x); y.y = siluf_(y.y); y.z = siluf_(y.z); y.w = siluf_(y.w);
                u32x2 wv; wv.x = cvt_pk_bf16(y.x, y.y); wv.y = cvt_pk_bf16(y.z, y.w); op[64 * j] = wv; }
        }
        __syncthreads();
    }
}

__device__ __forceinline__ void moe_tables(const Frame& F0, int layer) {
    const Frame F = phase_frame(F0);
    LAS int* tst = (LAS int*)(F.lds + L_TST);
    __syncthreads();
    if (F.tid < 16) tst[32 + F.tid] = (int)__hip_atomic_load(WSP(unsigned, WS_CTL) + CW_CNT + layer * 64 + F.tid, __ATOMIC_RELAXED, __HIP_MEMORY_SCOPE_AGENT);
    __syncthreads();
    if (F.tid == 0) { int a = 0; for (int e = 0; e < 16; ++e) { tst[e] = a; a += (tst[32 + e] + 255) >> 8; } tst[16] = a; }
    __syncthreads();
}

__device__ __forceinline__ void nr_phase(const Frame& F0, int layer, int T) {
    const Frame F = phase_frame(F0);
    LAS float* wl = (LAS float*)F.lds;
    LAS int* lcnt = (LAS int*)(F.lds + L_RT); LAS int* lbase = lcnt + 16; LAS int* rte = lcnt + 32; LAS int* rtp = rte + 128; LAS float* rtg = (LAS float*)(rtp + 128);
    const int lane = F.lane;
    for (int i = F.tid; i < NEXP * D / 4; i += NTHR) ((LAS f32x4*)wl)[i] = WSP(const f32x4, WS_WRT)[i];
    if (F.tid < 16) lcnt[F.tid] = 0;
    __syncthreads();
    const int rpb = (T + F.G - 1) / F.G, r0 = F.bx * rpb, r1 = (r0 + rpb) < T ? (r0 + rpb) : T;
    const f32x4* gn = (const f32x4*)(F.in[I_NFFN + F.z] + layer * D) + lane;
    float rb[16];
#pragma unroll
    for (int e = 0; e < 16; ++e) rb[e] = F.in[I_RB + F.z][e];
    for (int m = r0 + F.wave; m < r1; m += NWAVES) {
        const f32x4* xr = WSP(const f32x4, WS_X) + (size_t)m * (D / 4) + lane;
        f32x4 v[4]; float s = 0.f;
#pragma unroll
        for (int j = 0; j < 4; ++j) { v[j] = xr[64 * j]; s += (v[j].x * v[j].x + v[j].y * v[j].y) + (v[j].z * v[j].z + v[j].w * v[j].w); }
        const float rstd = 1.0f / sqrtf(wave_sum(s) * (1.0f / D) + EPS);
        const int bs = bsel_row(m);
        const f32x4* sh = (const f32x4*)mod_vec(F, layer, bs, 3) + lane; const f32x4* sc = (const f32x4*)mod_vec(F, layer, bs, 4) + lane;
        u32x2* o = (u32x2*)(WSP(bf16, WS_H) + (size_t)m * D) + lane;
#pragma unroll
        for (int j = 0; j < 4; ++j) { v[j] = v[j] * rstd * gn[64 * j] * (sc[64 * j] + 1.0f) + sh[64 * j]; u32x2 w; w.x = cvt_pk_bf16(v[j].x, v[j].y); w.y = cvt_pk_bf16(v[j].z, v[j].w); o[64 * j] = w; }
        float sg[16], sel[16];
#pragma unroll
        for (int e = 0; e < 16; ++e) {
            float p = 0.f;
#pragma unroll
            for (int j = 0; j < 4; ++j) { const f32x4 wv = *(const LAS f32x4*)(wl + e * D + 4 * lane + 256 * j); p += (v[j].x * wv.x + v[j].y * wv.y) + (v[j].z * wv.z + v[j].w * wv.w); }
            p = wave_sum(p);
            sg[e] = 1.0f / (1.0f + expf(-p)); sel[e] = sg[e] + rb[e];
        }
        float best = -3.0e38f, bs0 = 0.f, bs1 = 0.f; int be0 = 0, be1 = 1;
#pragma unroll
        for (int g = 0; g < 4; ++g) {
            float v1 = sel[4 * g], s1 = sg[4 * g], v2 = -3.0e38f, s2 = 0.f; int i1 = 0, i2 = 1;
#pragma unroll
            for (int k = 1; k < 4; ++k) { const float x = sel[4 * g + k], sx = sg[4 * g + k];
                if (x > v1) { v2 = v1; i2 = i1; s2 = s1; v1 = x; i1 = k; s1 = sx; } else if (x > v2) { v2 = x; i2 = k; s2 = sx; } }
            const float score = v1 + v2;
            if (score > best) { best = score; be0 = 4 * g + i1; be1 = 4 * g + i2; bs0 = s1; bs1 = s2; }
        }
        if (lane == 0) {
            const int lr = m - r0;
            const int p0 = __hip_atomic_fetch_add(lcnt + be0, 1, __ATOMIC_RELAXED, __HIP_MEMORY_SCOPE_WORKGROUP);
            const int p1 = __hip_atomic_fetch_add(lcnt + be1, 1, __ATOMIC_RELAXED, __HIP_MEMORY_SCOPE_WORKGROUP);
            const float inv = 1.0f / (bs0 + bs1);
            rte[lr] = be0 | (be1 << 8); rtp[lr] = p0 | (p1 << 16); rtg[2 * lr] = bs0 * inv; rtg[2 * lr + 1] = bs1 * inv;
        }
    }
    __syncthreads();
    if (F.tid < 16) lbase[F.tid] = (int)__hip_atomic_fetch_add(WSP(unsigned, WS_CTL) + CW_CNT + layer * 64 + F.tid, (unsigned)lcnt[F.tid], __ATOMIC_RELAXED, __HIP_MEMORY_SCOPE_AGENT);
    __syncthreads();
    for (int i = F.tid; i < 2 * (r1 - r0); i += NTHR) {
        const int lr = i >> 1, k = i & 1, m = r0 + lr;
        const int e = (rte[lr] >> (8 * k)) & 255, pos = lbase[e] + ((rtp[lr] >> (16 * k)) & 0xffff);
        WSP(int, WS_TOK)[e * TCAP + pos] = m;
        WSP(unsigned, WS_RINFO)[2 * m + k] = ((unsigned)e << 16) | (unsigned)pos;
        WSP(float, WS_RINFO + 512 * 1024)[2 * m + k] = rtg[2 * lr + k];
    }
}

__device__ __forceinline__ void cn_phase(const Frame& F0, int layer, int T, bool last) {
    const Frame F = phase_frame(F0);
    moe_tables(F, layer);
    const LAS int* tst = (const LAS int*)(F.lds + L_TST);
    const int gw = F.bx * NWAVES + F.wave, NGW = F.G * NWAVES, lane = F.lane;
    const f32x4* gn = (const f32x4*)(last ? F.in[I_NF + F.z] : F.in[I_NMIX + F.z] + (layer + 1) * D) + lane;
    for (int m = gw; m < T; m += NGW) {
        const unsigned r0 = WSP(const unsigned, WS_RINFO)[2 * m], r1 = WSP(const unsigned, WS_RINFO)[2 * m + 1];
        const int s0 = tst[r0 >> 16] * 256 + (int)(r0 & 0xffffu), s1 = tst[r1 >> 16] * 256 + (int)(r1 & 0xffffu);
        const float g0 = WSP(const float, WS_RINFO + 512 * 1024)[2 * m], g1 = WSP(const float, WS_RINFO + 512 * 1024)[2 * m + 1];
        const u32x2* y0 = (const u32x2*)(WSP(const bf16, WS_Y) + (size_t)s0 * D) + lane; const u32x2* y1 = (const u32x2*)(WSP(const bf16, WS_Y) + (size_t)s1 * D) + lane;
        f32x4* xr = WSP(f32x4, WS_X) + (size_t)m * (D / 4) + lane;
        const int bs = bsel_row(m);
        const f32x4* m5 = (const f32x4*)mod_vec(F, layer, bs, 5) + lane;
        f32x4 v[4]; float s = 0.f;
#pragma unroll
        for (int j = 0; j < 4; ++j) { const u32x2 a = y0[64 * j], b = y1[64 * j];
            const f32x4 ya = {bf_lo(a.x), bf_hi(a.x), bf_lo(a.y), bf_hi(a.y)}, yb = {bf_lo(b.x), bf_hi(b.x), bf_lo(b.y), bf_hi(b.y)};
            v[j] = xr[64 * j] + m5[64 * j] * (ya * g0 + yb * g1) * (((ABL_MASK & 8) || ((ABL_MASK >> (4 + layer)) & 1)) ? 0.f : MOE_FACTOR);
            s += (v[j].x * v[j].x + v[j].y * v[j].y) + (v[j].z * v[j].z + v[j].w * v[j].w); }
        const float rstd = 1.0f / sqrtf(wave_sum(s) * (1.0f / D) + EPS);
#ifdef PROBE_EXPR
        if (last) { float dq = 0.f;
#pragma unroll
            for (int j = 0; j < 4; ++j) { const f32x4 dd = v[j] - xr[64 * j]; dq += (dd.x * dd.x + dd.y * dd.y) + (dd.z * dd.z + dd.w * dd.w); }
            dq = wave_sum(dq); if (lane == 0) atomicAdd(WSP(float, WS_CTL) + 200, dq);
            float yq = 0.f;
#pragma unroll
            for (int j = 0; j < 4; ++j) { const u32x2 a = y0[64 * j]; yq += bf_lo(a.x) * bf_lo(a.x) + bf_hi(a.x) * bf_hi(a.x) + bf_lo(a.y) * bf_lo(a.y) + bf_hi(a.y) * bf_hi(a.y); }
            yq = wave_sum(yq); if (lane == 0) { atomicAdd(WSP(float, WS_CTL) + 201, yq); atomicAdd(WSP(float, WS_CTL) + 202, (g0 + g1) * 1024.f); } }
#endif
        if (last) {
            f32x4* o = (f32x4*)(F.out + (size_t)m * D) + lane;
#pragma unroll
            for (int j = 0; j < 4; ++j) o[64 * j] = v[j] * rstd * gn[64 * j];
        } else {
            const f32x4* sh = (const f32x4*)mod_vec(F, layer + 1, bs, 0) + lane; const f32x4* sc = (const f32x4*)mod_vec(F, layer + 1, bs, 1) + lane;
            u32x2* o = (u32x2*)(WSP(bf16, WS_H) + (size_t)m * D) + lane;
#pragma unroll
            for (int j = 0; j < 4; ++j) { xr[64 * j] = v[j]; const f32x4 h = v[j] * rstd * gn[64 * j] * (sc[64 * j] + 1.0f) + sh[64 * j]; u32x2 w; w.x = cvt_pk_bf16(h.x, h.y); w.y = cvt_pk_bf16(h.z, h.w); o[64 * j] = w; }
        }
    }
}

__device__ __forceinline__ void attn_phase(const Frame& F0, int slot) {
    const Frame F = phase_frame(F0);
    const bf16* Q = WSP(const bf16, WS_U1); const bf16* Kb = WSP(const bf16, WS_KB); const bf16* Vb = WSP(const bf16, WS_VB); bf16* O = WSP(bf16, WS_U2);
    LAS bf16* Ks = (LAS bf16*)F.lds;
    LAS bf16* Vt = (LAS bf16*)(F.lds + 9216);
    const int lane = F.lane, fr = lane & 15, fq = lane >> 4, wave = F.wave, tid = F.tid;
    constexpr int NUL = 2 * 128 * 4, NU = NUL + 2 * 4 * 4;
    for (int u = F.bx; u < NU; u += F.G) {
        int b, qb, kvh, qrow0; bool latent;
        if (u < NUL) { b = u >> 9; qb = (u & 511) >> 2; kvh = u & 3; qrow0 = b * SEQ + qb * 64; latent = true; }
        else { const int v = u - NUL; b = v >> 4; qb = (v & 15) >> 2; kvh = v & 3; qrow0 = ML + b * CTXL + qb * 64; latent = false; }
        const int hh = kvh * 4 + (wave >> 1), qoff = (wave & 1) * 32;
        bf16x8 qf[2][2];
#pragma unroll
        for (int rt = 0; rt < 2; ++rt)
#pragma unroll
            for (int ks = 0; ks < 2; ++ks) qf[rt][ks] = *(const bf16x8*)(Q + (size_t)(qrow0 + qoff + 16 * rt + fr) * D + hh * 64 + 32 * ks + 8 * fq);
        const float sink = F.in[I_SINK + F.z][slot * 16 + hh];
        float m_run[2] = {sink, sink}, l_run[2]; l_run[0] = l_run[1] = (fq == 0) ? 1.0f : 0.0f;
        f32x4 o[2][4];
#pragma unroll
        for (int rt = 0; rt < 2; ++rt)
#pragma unroll
            for (int dt = 0; dt < 4; ++dt) o[rt][dt] = (f32x4){0.f, 0.f, 0.f, 0.f};
        const int nch = latent ? 9 : 4;
        for (int c = 0; c < nch; ++c) {
            int krow0, s0 = 0; bool masked;
            if (latent && c < 5) { s0 = qb * 64 - 128 + 64 * c; if (s0 < 0 || s0 >= SEQ) continue; krow0 = b * SEQ + s0; masked = true; }
            else { const int cc = latent ? c - 5 : c; krow0 = ML + b * CTXL + 64 * cc; masked = false; }
            __syncthreads();
            { const int key = tid >> 3, pc = tid & 7;
              const u32x4 kv = *(const u32x4*)(Kb + (size_t)(krow0 + key) * 256 + kvh * 64 + pc * 8);
              const u32x4 vv = *(const u32x4*)(Vb + (size_t)(krow0 + key) * 256 + kvh * 64 + pc * 8);
              *(LAS u32x4*)(Ks + key * 72 + pc * 8) = kv;
              LAS bf16* vd = Vt + (pc * 8) * 72 + key;
              vd[0 * 72] = (bf16)(vv.x & 0xffffu); vd[1 * 72] = (bf16)(vv.x >> 16); vd[2 * 72] = (bf16)(vv.y & 0xffffu); vd[3 * 72] = (bf16)(vv.y >> 16);
              vd[4 * 72] = (bf16)(vv.z & 0xffffu); vd[5 * 72] = (bf16)(vv.z >> 16); vd[6 * 72] = (bf16)(vv.w & 0xffffu); vd[7 * 72] = (bf16)(vv.w >> 16); }
            __syncthreads();
            bf16x8 kf[4][2];
#pragma unroll
            for (int kt = 0; kt < 4; ++kt)
#pragma unroll
                for (int ks = 0; ks < 2; ++ks) kf[kt][ks] = *(const LAS bf16x8*)(Ks + (16 * kt + fr) * 72 + 32 * ks + 8 * fq);
#pragma unroll
            for (int rt = 0; rt < 2; ++rt) {
                f32x4 s[4];
#pragma unroll
                for (int kt = 0; kt < 4; ++kt) { s[kt] = (f32x4){0.f, 0.f, 0.f, 0.f};
#pragma unroll
                    for (int ks = 0; ks < 2; ++ks) s[kt] = __builtin_amdgcn_mfma_f32_16x16x32_bf16(kf[kt][ks], qf[rt][ks], s[kt], 0, 0, 0); }
                if (masked) { const int tq = qb * 64 + qoff + 16 * rt + fr;
#pragma unroll
                    for (int kt = 0; kt < 4; ++kt)
#pragma unroll
                        for (int j = 0; j < 4; ++j) { const int dlt = tq - (s0 + 16 * kt + 4 * fq + j); if (dlt > 128 || dlt < -128) s[kt][j] = NEG_INF; } }
                float mx = NEG_INF;
#pragma unroll
                for (int kt = 0; kt < 4; ++kt) mx = fmaxf(fmaxf(fmaxf(s[kt][0], s[kt][1]), fmaxf(s[kt][2], s[kt][3])), mx);
                mx = fmaxf(mx, __shfl_xor(mx, 16)); mx = fmaxf(mx, __shfl_xor(mx, 32));
                const float mnew = fmaxf(m_run[rt], mx), scl = __expf(m_run[rt] - mnew); m_run[rt] = mnew;
                float ps = 0.f;
#pragma unroll
                for (int kt = 0; kt < 4; ++kt)
#pragma unroll
                    for (int j = 0; j < 4; ++j) { s[kt][j] = __expf(s[kt][j] - mnew); ps += s[kt][j]; }
                l_run[rt] = l_run[rt] * scl + ps;
#pragma unroll
                for (int dt = 0; dt < 4; ++dt) o[rt][dt] = o[rt][dt] * scl;
#pragma unroll
                for (int kk = 0; kk < 2; ++kk) {
                    u32x4 pw; pw.x = cvt_pk_bf16(s[2 * kk][0], s[2 * kk][1]); pw.y = cvt_pk_bf16(s[2 * kk][2], s[2 * kk][3]); pw.z = cvt_pk_bf16(s[2 * kk + 1][0], s[2 * kk + 1][1]); pw.w = cvt_pk_bf16(s[2 * kk + 1][2], s[2 * kk + 1][3]);
                    const bf16x8 pf = __builtin_bit_cast(bf16x8, pw);
#pragma unroll
                    for (int dt = 0; dt < 4; ++dt) {
                        const u32x2 va = *(const LAS u32x2*)(Vt + (16 * dt + fr) * 72 + 32 * kk + 4 * fq), vb = *(const LAS u32x2*)(Vt + (16 * dt + fr) * 72 + 32 * kk + 16 + 4 * fq);
                        u32x4 vw; vw.x = va.x; vw.y = va.y; vw.z = vb.x; vw.w = vb.y;
                        o[rt][dt] = __builtin_amdgcn_mfma_f32_16x16x32_bf16(__builtin_bit_cast(bf16x8, vw), pf, o[rt][dt], 0, 0, 0);
                    }
                }
            }
        }
#pragma unroll
        for (int rt = 0; rt < 2; ++rt) {
            float l = l_run[rt]; l += __shfl_xor(l, 16); l += __shfl_xor(l, 32);
            const float inv = 1.0f / l;
            bf16* op = O + (size_t)(qrow0 + qoff + 16 * rt + fr) * D + hh * 64 + 4 * fq;
#pragma unroll
            for (int dt = 0; dt < 4; ++dt) { u32x2 w; w.x = cvt_pk_bf16(o[rt][dt][0] * inv, o[rt][dt][1] * inv); w.y = cvt_pk_bf16(o[rt][dt][2] * inv, o[rt][dt][3] * inv); *(u32x2*)(op + 16 * dt) = w; }
        }
    }
}

template <bool FINAL, bool REV>
__device__ __forceinline__ void scan_dir(const Frame& F, int slot, int b, int ck, int h, LAS bf16* us, LAS bf16* cs, f32x4 (&yacc)[4]) {
    constexpr int d = REV ? 1 : 0;
    const int tid = F.tid, lane = F.lane, fr = lane & 15, fq = lane >> 4, wave = F.wave;
    __syncthreads();
    {
        const int tau = tid >> 3, c0 = (tid & 7) * 16;
        const float* cw = F.in[I_LCW + F.z] + (size_t)((slot * 2 + d) * 4) * D + h * 128 + c0;
        const float* cb = F.in[I_LCB + F.z] + (size_t)(slot * 2 + d) * D + h * 128 + c0;
        float acc[16];
#pragma unroll
        for (int i = 0; i < 16; i += 4) { const f32x4 bv = *(const f32x4*)(cb + i); acc[i] = bv.x; acc[i + 1] = bv.y; acc[i + 2] = bv.z; acc[i + 3] = bv.w; }
#pragma unroll
        for (int k = 0; k < 4; ++k) {
            const int row = tau + 3 + (REV ? (3 - k) : -(3 - k));
            const u32x4 ua = *(const LAS u32x4*)(us + row * 136 + c0), ub = *(const LAS u32x4*)(us + row * 136 + c0 + 8);
            const unsigned uw[8] = {ua.x, ua.y, ua.z, ua.w, ub.x, ub.y, ub.z, ub.w};
#pragma unroll
            for (int i = 0; i < 16; i += 4) { const f32x4 wv = *(const f32x4*)(cw + (size_t)k * D + i);
                acc[i] += wv.x * bf_lo(uw[i / 2]); acc[i + 1] += wv.y * bf_hi(uw[i / 2]); acc[i + 2] += wv.z * bf_lo(uw[i / 2 + 1]); acc[i + 3] += wv.w * bf_hi(uw[i / 2 + 1]); }
        }
        u32x4 oa, ob; oa.x = cvt_pk_bf16(acc[0], acc[1]); oa.y = cvt_pk_bf16(acc[2], acc[3]); oa.z = cvt_pk_bf16(acc[4], acc[5]); oa.w = cvt_pk_bf16(acc[6], acc[7]);
        ob.x = cvt_pk_bf16(acc[8], acc[9]); ob.y = cvt_pk_bf16(acc[10], acc[11]); ob.z = cvt_pk_bf16(acc[12], acc[13]); ob.w = cvt_pk_bf16(acc[14], acc[15]);
        *(LAS u32x4*)(cs + tau * 136 + c0) = oa; *(LAS u32x4*)(cs + tau * 136 + c0 + 8) = ob;
    }
    __syncthreads();
    const int ch16 = wave * 16, chn = h * 128 + ch16 + fr;
    const bf16* wat = WSP(const bf16, WS_WAXT) + (size_t)((d * 8 + h) * 2) * 16384 + (size_t)(ch16 + fr) * 128 + 8 * fq;
    f32x4 ar[4], ax[4];
#pragma unroll
    for (int mt = 0; mt < 4; ++mt) { ar[mt] = (f32x4){0.f, 0.f, 0.f, 0.f}; ax[mt] = (f32x4){0.f, 0.f, 0.f, 0.f}; }
#pragma unroll
    for (int ks = 0; ks < 4; ++ks) {
        const bf16x8 wa = *(const bf16x8*)(wat + 32 * ks), wx = *(const bf16x8*)(wat + 16384 + 32 * ks);
#pragma unroll
        for (int mt = 0; mt < 4; ++mt) { const bf16x8 af = *(const LAS bf16x8*)(cs + (16 * mt + fr) * 136 + 32 * ks + 8 * fq);
            ar[mt] = __builtin_amdgcn_mfma_f32_16x16x32_bf16(af, wa, ar[mt], 0, 0, 0); ax[mt] = __builtin_amdgcn_mfma_f32_16x16x32_bf16(af, wx, ax[mt], 0, 0, 0); }
    }
    const float ba_ = F.in[I_BA + F.z][(slot * 2 + d) * D + chn], bx_ = F.in[I_BX + F.z][(slot * 2 + d) * D + chn], lam = F.in[I_LAM + F.z][(slot * 2 + d) * D + chn];
    const float nsp8 = -8.0f * log1pf(expf(-lam));
    const int cprime = REV ? (ck < 4 ? 3 - ck : 135 - ck) : ck;
    const size_t sidx = ((size_t)((b * 2 + d) * NCHUNK + cprime)) * D + chn;
    float hrun = 0.f, At = 1.f;
    if (FINAL) hrun = WSP(const float, WS_CARRY)[sidx];
#pragma unroll
    for (int mi = 0; mi < 4; ++mi) {
        const int mt = REV ? 3 - mi : mi;
        float a[4], bb[4];
#pragma unroll
        for (int j = 0; j < 4; ++j) {
            const int tau = 16 * mt + 4 * fq + j;
            const float r = sigmoidf_(ar[mt][j] + ba_), gi = sigmoidf_(ax[mt][j] + bx_);
            a[j] = __expf(nsp8 * r);
            const float cv = __builtin_bit_cast(float, (unsigned)cs[tau * 136 + ch16 + fr] << 16);
            bb[j] = sqrtf(fmaxf(1.0f - a[j] * a[j], 0.f)) * gi * cv;
        }
        float A4, B4;
        if (!REV) { A4 = a[0] * a[1] * a[2] * a[3]; B4 = ((bb[0] * a[1] + bb[1]) * a[2] + bb[2]) * a[3] + bb[3]; }
        else      { A4 = a[0] * a[1] * a[2] * a[3]; B4 = ((bb[3] * a[2] + bb[2]) * a[1] + bb[1]) * a[0] + bb[0]; }
        float Aq[4], Bq[4];
#pragma unroll
        for (int q = 0; q < 4; ++q) { Aq[q] = __shfl(A4, fr + 16 * q); Bq[q] = __shfl(B4, fr + 16 * q); }
        if (FINAL) {
            float hq = hrun;
#pragma unroll
            for (int qi = 0; qi < 4; ++qi) { const int q = REV ? 3 - qi : qi; const bool before = REV ? (q > fq) : (q < fq); if (before) hq = Aq[q] * hq + Bq[q]; }
            if (!REV) { float hv = hq;
#pragma unroll
                for (int j = 0; j < 4; ++j) { hv = a[j] * hv + bb[j]; yacc[mt][j] += hv; } }
            else { float hv = hq;
#pragma unroll
                for (int j = 3; j >= 0; --j) { hv = a[j] * hv + bb[j]; yacc[mt][j] += hv; } }
        }
#pragma unroll
        for (int qi = 0; qi < 4; ++qi) { const int q = REV ? 3 - qi : qi; hrun = Aq[q] * hrun + Bq[q]; At *= Aq[q]; }
    }
    if (!FINAL && fq == 0) { WSP(float, WS_SUMA)[sidx] = At; WSP(float, WS_SUMB)[sidx] = hrun; }
}

template <bool FINAL>
__device__ __forceinline__ void scan_phase(const Frame& F0, int slot) {
    const Frame F = phase_frame(F0);
    const bf16* U = WSP(const bf16, WS_U1);
    LAS bf16* us = (LAS bf16*)F.lds;
    LAS bf16* cs = (LAS bf16*)(F.lds + 19456);
    LAS float* yt = (LAS float*)(F.lds + 36864);
    const int tid = F.tid, lane = F.lane, fr = lane & 15, fq = lane >> 4;
    constexpr int NU = 2 * NCHUNK * 8;
    for (int u = F.bx; u < NU; u += F.G) {
        const int h = u & 7, ck = (u >> 3) % NCHUNK, b = u / (8 * NCHUNK);
        int m0, lo, hi;
        if (ck < 4) { lo = ML + b * CTXL; hi = lo + CTXL; m0 = lo + ck * 64; } else { lo = b * SEQ; hi = lo + SEQ; m0 = lo + (ck - 4) * 64; }
        __syncthreads();
        for (int i = tid; i < 70 * 16; i += NTHR) { const int r = i >> 4, pc = i & 15, row = m0 - 3 + r;
            u32x4 v = {0u, 0u, 0u, 0u}; if (row >= lo && row < hi) v = *(const u32x4*)(U + (size_t)row * D + h * 128 + pc * 8);
            *(LAS u32x4*)(us + r * 136 + pc * 8) = v; }
        f32x4 yacc[4];
#pragma unroll
        for (int mt = 0; mt < 4; ++mt) yacc[mt] = (f32x4){0.f, 0.f, 0.f, 0.f};
        scan_dir<FINAL, false>(F, slot, b, ck, h, us, cs, yacc);
        scan_dir<FINAL, true>(F, slot, b, ck, h, us, cs, yacc);
        if (FINAL) {
#pragma unroll
            for (int mt = 0; mt < 4; ++mt)
#pragma unroll
                for (int j = 0; j < 4; ++j) yt[(16 * mt + 4 * fq + j) * 128 + F.wave * 16 + fr] = yacc[mt][j];
            __syncthreads();
            const int tau = tid >> 3, c0 = (tid & 7) * 16;
            const bf16* gp = WSP(const bf16, WS_G) + (size_t)(m0 + tau) * D + h * 128 + c0;
            const u32x4 ga = *(const u32x4*)gp, gb = *(const u32x4*)(gp + 8);
            const unsigned gw[8] = {ga.x, ga.y, ga.z, ga.w, gb.x, gb.y, gb.z, gb.w};
            unsigned ow[8];
#pragma unroll
            for (int i = 0; i < 8; ++i) { const f32x2 yv = *(const LAS f32x2*)(yt + tau * 128 + c0 + 2 * i); ow[i] = cvt_pk_bf16(yv.x * bf_lo(gw[i]), yv.y * bf_hi(gw[i])); }
            bf16* op = WSP(bf16, WS_U2) + (size_t)(m0 + tau) * D + h * 128 + c0;
            *(u32x4*)op = (u32x4){ow[0], ow[1], ow[2], ow[3]}; *(u32x4*)(op + 8) = (u32x4){ow[4], ow[5], ow[6], ow[7]};
        }
    }
}

__device__ __forceinline__ void carry_phase(const Frame& F0) {
    const Frame F = phase_frame(F0);
    if (F.tid >= 64 || F.bx >= 64) return;
    const int g = F.bx * 64 + F.tid, bd = g >> 10, chn = g & 1023;
    const size_t base = (size_t)bd * NCHUNK * D + chn;
    const float* SA = WSP(const float, WS_SUMA) + base; const float* SB = WSP(const float, WS_SUMB) + base; float* CR = WSP(float, WS_CARRY) + base;
    float hv = 0.f;
    for (int c0 = 0; c0 < NCHUNK; c0 += 12) {
        float a[12], bq[12];
#pragma unroll
        for (int i = 0; i < 12; ++i) { a[i] = SA[(size_t)(c0 + i) * D]; bq[i] = SB[(size_t)(c0 + i) * D]; }
#pragma unroll
        for (int i = 0; i < 12; ++i) { CR[(size_t)(c0 + i) * D] = hv; hv = a[i] * hv + bq[i]; }
    }
}

template <int layer>
__device__ __forceinline__ void layer_body(const Frame& F0, const XcdBarrier& bar, LAS unsigned* gtab, const LAS int* tst) {
    const Frame F = phase_frame(F0);
#define GB() xcd_barrier(bar)
        constexpr int kind = layer % 3; constexpr bool last = layer == 3; constexpr int Mrows = last ? ML : MT, nM = Mrows / 256;
        const bf16* B2; const float* bias2;
        if constexpr (kind == 0) {
            const int slot = layer / 3;
            { DenseSched S; S.init(WSP(bf16, WS_H), WSP(bf16, WS_PW1T) + (size_t)slot * 2048 * 1024, 1024, nM, 8, F.G, F.bx);
              EpiGlu<0> E{WSP(bf16, WS_U1), D, F.in[I_PW1B + F.z] + slot * 2048};
              g8::gemm_phase<1024, false>(F.lds, gtab, S, E); }
            GB();
            dw_phase(F, slot, Mrows, WSP(const bf16, WS_U1), WSP(bf16, WS_U2));
            GB();
            B2 = WSP(const bf16, WS_PW2T) + (size_t)slot * 1024 * 1024; bias2 = F.in[I_PW2B + F.z] + slot * D;
        } else if constexpr (kind == 1) {
            { DenseSched S; S.init(WSP(bf16, WS_H), WSP(bf16, WS_QKVT), 1024, nM, 6, F.G, F.bx);
              EpiQkv E{WSP(bf16, WS_U1), WSP(bf16, WS_KB), WSP(bf16, WS_VB), WSP(const float, WS_ROPE)};
              g8::gemm_phase<1024, false>(F.lds, gtab, S, E); }
            GB();
            attn_phase(F, 0);
            GB();
            B2 = WSP(const bf16, WS_WOT); bias2 = nullptr;
        } else {
            { DenseSched S; S.init(WSP(bf16, WS_H), WSP(bf16, WS_WINT), 1024, nM, 8, F.G, F.bx);
              EpiBf16 E{WSP(bf16, WS_U1), WSP(bf16, WS_G), 4, D};
              g8::gemm_phase<1024, false>(F.lds, gtab, S, E); }
            GB();
            scan_phase<false>(F, 0);
            GB();
            carry_phase(F);
            GB();
            scan_phase<true>(F, 0);
            GB();
            B2 = WSP(const bf16, WS_WOUTT); bias2 = nullptr;
        }
        {
            DenseSched S; S.init(WSP(bf16, WS_U2), B2, 1024, nM, 4, F.G, F.bx);
            EpiRes E; E.xl = layer == 0 ? F.in[I_X + F.z] : WSP(const float, WS_X); E.xc = layer == 0 ? F.in[I_CTX + F.z] : WSP(const float, WS_X) + (size_t)ML * D;
            E.X = WSP(float, WS_X); E.bias = bias2; E.gate = mod_vec(F, layer, 0, 2); E.gscale = ((ABL_MASK >> kind) & 1) ? 0.f : 1.f;
            g8::gemm_phase<1024, false>(F.lds, gtab, S, E);
        }
        GB();
        nr_phase(F, layer, Mrows);
        GB();
        moe_tables(F, layer);
        {   MoeSched S; S.A = (const char*)WSP(bf16, WS_H); S.B = (const char*)(WSP(bf16, WS_W13T) + (size_t)layer * 16 * 1024 * 1024); S.aT = 0; S.bE = (size_t)1024 * 1024 * 2; S.bT = (size_t)256 * 1024 * 2;
            S.G = F.G; S.c = F.bx; S.tst = tst; S.tok = WSP(const int, WS_TOK); S.gather = true;
            EpiGlu<1> E{WSP(bf16, WS_HID), DEXP, nullptr};
            g8::gemm_phase<1024, true>(F.lds, gtab, S, E); }
        GB();
        {   MoeSched S; S.A = (const char*)WSP(bf16, WS_HID); S.B = (const char*)(WSP(bf16, WS_W2T) + (size_t)layer * 16 * 1024 * 512); S.aT = (size_t)256 * 512 * 2; S.bE = (size_t)1024 * 512 * 2; S.bT = (size_t)256 * 512 * 2;
            S.G = F.G; S.c = F.bx; S.tst = tst; S.tok = WSP(const int, WS_TOK); S.gather = false;
            EpiBf16 E{WSP(bf16, WS_Y), WSP(bf16, WS_Y), 99, D};
            g8::gemm_phase<512, false>(F.lds, gtab, S, E); }
        GB();
        cn_phase(F, layer, Mrows, last);
        if (!last) GB();
#undef GB
}

__device__ __forceinline__ float probe_val(const Frame& F) {
    const u32x2 r0 = WSP(const u32x2, WS_RINFO)[2 * PROBE_M0], r1 = WSP(const u32x2, WS_RINFO)[2 * PROBE_M0 + 1];
    return (float)(r0.y & 0xffffu) * 1.0f + (float)(r0.y >> 16) * 100.0f + (float)(r1.y & 0xffffu) * 10000.f;
}
__global__ void __launch_bounds__(NTHR, 2) fwd_kernel(Params prm) {
    extern __shared__ __attribute__((aligned(16))) unsigned char lds_raw[];
    Frame F;
    F.lds = (LAS unsigned char*)lds_raw;
    F.tid = threadIdx.x; F.lane = F.tid & 63; F.wave = __builtin_amdgcn_readfirstlane(F.tid >> 6); F.G = gridDim.x; F.bx = blockIdx.x;
    F.in = prm.in; F.out = prm.out; F.ws = prm.ws; F.z = 0;
    volatile LAS unsigned* MISC = (volatile LAS unsigned*)(F.lds + L_MISC);
    if (F.tid < 16) MISC[F.tid] = 0u;
    __syncthreads();
    XcdBarrier bar = xcd_barrier_post(WSP(unsigned, WS_CTL) + CW_BAR, MISC);
#define GB() xcd_barrier(bar)
    LAS unsigned* gtab = (LAS unsigned*)(F.lds + L_GTAB);
    const LAS int* tst = (const LAS int*)(F.lds + L_TST);

    p0a_phase(F); GB();
    p0b_phase(F); GB();
    norm_phase(F, true, 0, MT); GB();

    layer_body<0>(F, bar, gtab, tst);
    layer_body<1>(F, bar, gtab, tst);
    layer_body<2>(F, bar, gtab, tst);
    layer_body<3>(F, bar, gtab, tst);
#ifdef PROBE_EXPR
    xcd_barrier(bar);
    { const float q = PROBE_EXPR; const float v = sqrtf(q);
      for (size_t i = (size_t)F.bx * NTHR + F.tid; i < (size_t)ML * D; i += (size_t)F.G * NTHR) F.out[i] = v; }
#endif
#undef GB
}

extern "C" void kernel_launch(void* const* d_in, const int* in_sizes, int n_in, void* d_out, int out_size, void* d_ws, size_t ws_size, hipStream_t stream) {
    static int grid = 0;
    if (grid == 0) {
        if (n_in != 34 || out_size != ML * D || ws_size < WS_END) { fprintf(stderr, "kernel_launch: unexpected problem (n_in %d, out %d, ws %zu)\n", n_in, out_size, ws_size); grid = -1; return; }
        int dev = 0, cus = 0, per_cu = 0;
        if (hipGetDevice(&dev) != hipSuccess || hipDeviceGetAttribute(&cus, hipDeviceAttributeMultiprocessorCount, dev) != hipSuccess) { grid = -1; return; }
        if (hipFuncSetAttribute((const void*)fwd_kernel, hipFuncAttributeMaxDynamicSharedMemorySize, LDS_BYTES) != hipSuccess) { fprintf(stderr, "kernel_launch: hipFuncSetAttribute failed\n"); grid = -1; return; }
        if (hipOccupancyMaxActiveBlocksPerMultiprocessor(&per_cu, (const void*)fwd_kernel, NTHR, LDS_BYTES) != hipSuccess || per_cu < 1) { fprintf(stderr, "kernel_launch: occupancy query says %d\n", per_cu); }
        (void)hipGetLastError();
        grid = cus;
        if (grid > 256) grid = 256;
    }
    if (grid < 0) return;
    (void)hipMemsetAsync((char*)d_ws + WS_CTL, 0, CTL_ZERO_BYTES, stream);
    Params p{};
    for (int i = 0; i < 34; ++i) p.in[i] = (const float*)d_in[i];
    p.out = (float*)d_out; p.ws = (unsigned char*)d_ws;
    hipLaunchKernelGGL(fwd_kernel, dim3(grid), dim3(NTHR), LDS_BYTES, stream, p);
}
```
